# Optimizing an MI355X kernel written in HIP

```python
import jax, jax.numpy as jnp
from jax import lax
import numpy as np

D_MODEL = 1024
BATCH = 16
SEQ = 2048
DEPTH = 2

GRID_W = 64
CTX_LEN = 256
N_MIXERS = 2
N_HEADS = 16
N_KV_HEADS = 4
HEAD_DIM = 64
GROUP = N_HEADS // N_KV_HEADS
Q_WIDTH = N_HEADS * HEAD_DIM
KV_WIDTH = N_KV_HEADS * HEAD_DIM
WINDOW = 128
BLOCK = 128
SPAN = BLOCK + 2 * WINDOW
ROPE_BASE = 10000.0
AXIS_DIM = HEAD_DIM // 2
FOURIER_GROUPS = 4
FOURIER_GROUP_CH = D_MODEL // FOURIER_GROUPS
D_FF = 2816
N_MOD = 9
LN_EPS = 1e-5
ALPHA = (2.0 * DEPTH) ** 0.25
BETA = (8.0 * DEPTH) ** -0.25
NEG_INF = -1e30
N_ATTN_LAYERS = (DEPTH + N_MIXERS - 1) // N_MIXERS
N_FOURIER_LAYERS = (DEPTH + N_MIXERS - 2) // N_MIXERS

kernel_name = "hybrid_window_sink_gqa_fnet_macaron_deepnorm"


def layer_norm(x, g, b):
    xf = x.astype(jnp.float32)
    mu = xf.mean(-1, keepdims=True)
    var = jnp.square(xf - mu).mean(-1, keepdims=True)
    return ((xf - mu) * lax.rsqrt(var + LN_EPS) * g + b).astype(x.dtype)


def modulate(x, mod, j):
    shift, scale = mod[:, 3 * j], mod[:, 3 * j + 1]
    return x * (1 + scale[:, None, :]) + shift[:, None, :]


def post_norm_update(x, y, mod, j, g, b):
    gate = mod[:, 3 * j + 2][:, None, :]
    return layer_norm(ALPHA * x + gate * y, g, b)


def swiglu(h, wi, wo):
    a, g = jnp.split(h @ wi, 2, axis=-1)
    return (a * jax.nn.silu(g)) @ wo


def half_ffn_sublayer(x, mod, j, wi, wo, g, b):
    y = 0.5 * swiglu(modulate(x, mod, j), wi, wo)
    return post_norm_update(x, y, mod, j, g, b)


def axial_rope_tables(n_tokens):
    rows = n_tokens // GRID_W
    row = jnp.repeat(jnp.arange(rows), GRID_W).astype(jnp.float32)
    col = jnp.tile(jnp.arange(GRID_W), rows).astype(jnp.float32)
    inv = ROPE_BASE ** (-jnp.arange(0, AXIS_DIM, 2, dtype=jnp.float32) / AXIS_DIM)
    ang = jnp.concatenate([row[:, None] * inv, col[:, None] * inv], axis=-1)
    return jnp.cos(ang), jnp.sin(ang)


def apply_axial_rope(x, cos, sin):
    B_, L_, H_, Dh = x.shape
    half = AXIS_DIM // 2
    xr = x.astype(jnp.float32).reshape(B_, L_, H_, 2, 2, half)
    x1, x2 = xr[..., 0, :], xr[..., 1, :]
    c = cos.reshape(L_, 1, 2, half)
    s = sin.reshape(L_, 1, 2, half)
    out = jnp.stack([x1 * c - x2 * s, x1 * s + x2 * c], axis=-2)
    return out.reshape(B_, L_, H_, Dh).astype(x.dtype)


def window_sink_attention(h, hc, w_qkv, b_qkv, w_o, sink, cos, sin, ctx_queries):
    B_, S_, _ = h.shape
    C_ = hc.shape[1]
    n_blocks = S_ // BLOCK
    scale = HEAD_DIM ** -0.5
    q, k, v = jnp.split(h @ w_qkv + b_qkv, [Q_WIDTH, Q_WIDTH + KV_WIDTH], axis=-1)
    q = apply_axial_rope(q.reshape(B_, S_, N_HEADS, HEAD_DIM) * scale, cos, sin)
    q = q.reshape(B_, S_, N_KV_HEADS, GROUP, HEAD_DIM)
    k = apply_axial_rope(k.reshape(B_, S_, N_KV_HEADS, HEAD_DIM), cos, sin)
    v = v.reshape(B_, S_, N_KV_HEADS, HEAD_DIM)
    kvc = hc @ w_qkv[:, Q_WIDTH:] + b_qkv[Q_WIDTH:]
    kc, vc = jnp.split(kvc, [KV_WIDTH], axis=-1)
    kc = kc.reshape(B_, C_, N_KV_HEADS, HEAD_DIM)
    vc = vc.reshape(B_, C_, N_KV_HEADS, HEAD_DIM)

    pad = ((0, 0), (WINDOW, WINDOW), (0, 0), (0, 0))
    k_pad = jnp.pad(k, pad)
    v_pad = jnp.pad(v, pad)
    sink_logit = sink.astype(jnp.float32).reshape(1, N_KV_HEADS, GROUP, 1, 1)
    rel = jnp.arange(BLOCK)[:, None] - jnp.arange(SPAN)[None, :] + WINDOW
    band = jnp.abs(rel) <= WINDOW

    def block(bi):
        start = bi * BLOCK
        q_b = lax.dynamic_slice_in_dim(q, start, BLOCK, axis=1)
        k_b = lax.dynamic_slice_in_dim(k_pad, start, SPAN, axis=1)
        v_b = lax.dynamic_slice_in_dim(v_pad, start, SPAN, axis=1)
        key_pos = start - WINDOW + jnp.arange(SPAN)
        valid = band & ((key_pos >= 0) & (key_pos < S_))[None, :]
        s_win = jnp.einsum('bqhgd,bkhd->bhgqk', q_b, k_b, preferred_element_type=jnp.float32)
        s_win = jnp.where(valid, s_win, NEG_INF)
        s_ctx = jnp.einsum('bqhgd,bkhd->bhgqk', q_b, kc, preferred_element_type=jnp.float32)
        sinks = jnp.broadcast_to(sink_logit, s_ctx.shape[:-1] + (1,))
        p = jax.nn.softmax(jnp.concatenate([s_win, s_ctx, sinks], axis=-1), axis=-1).astype(v.dtype)
        o = (jnp.einsum('bhgqk,bkhd->bqhgd', p[..., :SPAN], v_b)
             + jnp.einsum('bhgqk,bkhd->bqhgd', p[..., SPAN:SPAN + C_], vc))
        return o

    o = lax.map(block, jnp.arange(n_blocks))
    o = jnp.moveaxis(o, 0, 1).reshape(B_, S_, Q_WIDTH)
    y = o @ w_o
    if not ctx_queries:
        return y, None
    qc = (hc @ w_qkv[:, :Q_WIDTH] + b_qkv[:Q_WIDTH]) * scale
    qc = qc.reshape(B_, C_, N_KV_HEADS, GROUP, HEAD_DIM)
    sc = jnp.einsum('bqhgd,bkhd->bhgqk', qc, kc, preferred_element_type=jnp.float32)
    sinks_c = jnp.broadcast_to(sink_logit, sc.shape[:-1] + (1,))
    pc = jax.nn.softmax(jnp.concatenate([sc, sinks_c], axis=-1), axis=-1).astype(vc.dtype)
    oc = jnp.einsum('bhgqk,bkhd->bqhgd', pc[..., :C_], vc).reshape(B_, C_, Q_WIDTH)
    return y, oc @ w_o


def fourier_mix(h, w_o):
    B_, L_, D_ = h.shape
    hg = h.astype(jnp.float32).reshape(B_, L_, FOURIER_GROUPS, FOURIER_GROUP_CH)
    f = jnp.fft.fft2(hg, axes=(1, 3), norm="ortho").real
    return f.reshape(B_, L_, D_).astype(h.dtype) @ w_o


def setup_inputs(seed: int = 0) -> dict:
    key = jax.random.key(seed)
    ks = jax.random.split(key, 16)

    def nrm(k, shape, s):
        return jax.random.normal(k, shape, jnp.float32) * s

    qkv_w = Q_WIDTH + 2 * KV_WIDTH
    return {
        "x": nrm(ks[0], (BATCH, SEQ, D_MODEL), 1.0),
        "c": nrm(ks[1], (BATCH, D_MODEL), 1.0),
        "ctx": nrm(ks[2], (BATCH, CTX_LEN, D_MODEL), 1.0),
        "c_ctx": nrm(ks[3], (D_MODEL,), 1.0),
        "mod_w": nrm(ks[4], (DEPTH, D_MODEL, N_MOD * D_MODEL), D_MODEL ** -0.5),
        "mod_b": nrm(ks[5], (DEPTH, N_MOD * D_MODEL), 0.02),
        "ln_g": 1.0 + nrm(ks[6], (DEPTH, 3, D_MODEL), 0.02),
        "ln_b": nrm(ks[7], (DEPTH, 3, D_MODEL), 0.02),
        "ffn_wi": nrm(ks[8], (DEPTH, 2, D_MODEL, 2 * D_FF), D_MODEL ** -0.5),
        "ffn_wo": nrm(ks[9], (DEPTH, 2, D_FF, D_MODEL), BETA * D_FF ** -0.5),
        "attn_wqkv": nrm(ks[10], (N_ATTN_LAYERS, D_MODEL, qkv_w), D_MODEL ** -0.5),
        "attn_bqkv": nrm(ks[11], (N_ATTN_LAYERS, qkv_w), 0.02),
        "attn_wo": nrm(ks[12], (N_ATTN_LAYERS, Q_WIDTH, D_MODEL), BETA * Q_WIDTH ** -0.5),
        "attn_sink": nrm(ks[13], (N_ATTN_LAYERS, N_HEADS), 1.0),
        "fourier_wo": nrm(ks[14], (N_FOURIER_LAYERS, D_MODEL, D_MODEL), BETA * D_MODEL ** -0.5),
    }


def reference(x, c, ctx, c_ctx, mod_w, mod_b, ln_g, ln_b, ffn_wi, ffn_wo,
              attn_wqkv, attn_bqkv, attn_wo, attn_sink, fourier_wo):
    cos, sin = axial_rope_tables(x.shape[1])
    silu_c = jax.nn.silu(c)
    silu_cc = jax.nn.silu(c_ctx)
    ctx_s = ctx
    for i in range(DEPTH):
        kind = i % N_MIXERS
        ctx_out_live = any(j % N_MIXERS == 0 for j in range(i + 1, DEPTH))
        ctx_in_live = (kind == 0) or ctx_out_live
        g, b = ln_g[i], ln_b[i]
        mod_lat = (silu_c @ mod_w[i] + mod_b[i]).reshape(-1, N_MOD, D_MODEL)
        x = half_ffn_sublayer(x, mod_lat, 0, ffn_wi[i, 0], ffn_wo[i, 0], g[0], b[0])
        if ctx_in_live:
            mod_ctx = (silu_cc @ mod_w[i] + mod_b[i]).reshape(1, N_MOD, D_MODEL)
            ctx_s = half_ffn_sublayer(ctx_s, mod_ctx, 0, ffn_wi[i, 0], ffn_wo[i, 0], g[0], b[0])
        h = modulate(x, mod_lat, 1)
        if kind == 0:
            a = i // N_MIXERS
            y, yc = window_sink_attention(h, modulate(ctx_s, mod_ctx, 1), attn_wqkv[a], attn_bqkv[a],
                                          attn_wo[a], attn_sink[a], cos, sin, ctx_out_live)
        else:
            f = i // N_MIXERS
            y = fourier_mix(h, fourier_wo[f])
            yc = fourier_mix(modulate(ctx_s, mod_ctx, 1), fourier_wo[f]) if ctx_out_live else None
        x = post_norm_update(x, y, mod_lat, 1, g[1], b[1])
        x = half_ffn_sublayer(x, mod_lat, 2, ffn_wi[i, 1], ffn_wo[i, 1], g[2], b[2])
        if ctx_out_live:
            ctx_s = post_norm_update(ctx_s, yc, mod_ctx, 1, g[1], b[1])
            ctx_s = half_ffn_sublayer(ctx_s, mod_ctx, 2, ffn_wi[i, 1], ffn_wo[i, 1], g[2], b[2])
    return x
```

```cpp
#include <hip/hip_runtime.h>
#include <hip/hip_cooperative_groups.h>
#include <cstdio>
#include <cstdint>
namespace cg = cooperative_groups;

#define LAS __attribute__((address_space(3)))
typedef unsigned short bf16_t;
typedef short bf16x8 __attribute__((ext_vector_type(8)));
typedef float f32x2 __attribute__((ext_vector_type(2)));
typedef float f32x4 __attribute__((ext_vector_type(4)));
typedef float f32x16 __attribute__((ext_vector_type(16)));
typedef unsigned u32x2 __attribute__((ext_vector_type(2)));
typedef unsigned u32x4 __attribute__((ext_vector_type(4)));

constexpr int DM = 1024, NB = 16, SEQ = 2048, CTXL = 256, DFF = 2816, NMOD = 9;
constexpr int MLAT = NB * SEQ, MCTX = NB * CTXL, MTOT = MLAT + MCTX;
constexpr int QKVW = 1536;
constexpr float LN_EPS = 1e-5f;
constexpr float ALPHA = 1.41421356237309515f;
constexpr float LOG2E = 1.4426950408889634f;
constexpr float QSCALE = 0.125f * LOG2E;

constexpr size_t MiB = 1u << 20;
constexpr size_t WS_MOD = 1 * MiB;
constexpr size_t WS_STATS = 3 * MiB;
constexpr size_t WS_ROPE = 8 * MiB;
constexpr size_t WS_WCS = 9 * MiB;
constexpr size_t WS_WQKV = 13 * MiB;
constexpr size_t WS_AWO = 16 * MiB;
constexpr size_t WS_WI = 18 * MiB;
constexpr size_t WS_WO = 62 * MiB;
constexpr size_t WS_X = 84 * MiB;
constexpr size_t WS_H = 228 * MiB;
constexpr size_t WS_HID = 300 * MiB;
constexpr size_t WS_Q = WS_HID;
constexpr size_t WS_O = WS_HID + 64 * MiB;
constexpr size_t WS_K = WS_HID + 128 * MiB;
constexpr size_t WS_VTL = WS_HID + 146 * MiB;
constexpr size_t WS_VTC = WS_HID + 162 * MiB;
constexpr size_t WS_P = WS_HID;
constexpr size_t WS_T = WS_HID + 176 * MiB;
constexpr size_t WS_END = 498 * MiB;
constexpr size_t WI_BYTES = (size_t)2 * DFF * DM * 2, WO_BYTES = (size_t)DM * DFF * 2;

constexpr int LDS_BYTES = 147456;

__device__ __forceinline__ unsigned f2bf(float f) { unsigned u = __builtin_bit_cast(unsigned, f); return (u + 0x7fffu + ((u >> 16) & 1u)) >> 16; }
__device__ __forceinline__ unsigned pk2(float lo, float hi) { return f2bf(lo) | (f2bf(hi) << 16); }
__device__ __forceinline__ unsigned cvt_pk_bf16(float lo, float hi) { unsigned r; asm("v_cvt_pk_bf16_f32 %0, %1, %2" : "=v"(r) : "v"(lo), "v"(hi)); return r; }

namespace pg8 {
constexpr int BM = 256, BK = 64, HALF = 128, HTB = HALF * BK * 2, STAGE_BYTES = 8 * HTB, NXCD = 8, WGM = 8;
__host__ __device__ __forceinline__ int lds_byte(int r, int c) { const int st = (r >> 4) * 2 + (c >> 5), rr = r & 15, cc = c & 31, ob = rr * 64 + cc * 2; return st * 1024 + (ob ^ (((ob >> 9) & 1) << 5)); }
__host__ __device__ __forceinline__ void stage_rc(int b, int& R, int& C) { const int st = b / 1024, sb = b % 1024, swz = sb ^ (((sb >> 9) & 1) << 5); R = (st >> 1) * 16 + swz / 64; C = (st & 1) * 32 + (swz % 64) / 2; }
__host__ __device__ __forceinline__ int perm32(int rho) { const int n = rho >> 4, i = rho & 15; return 8 * (i >> 2) + 4 * n + (i & 3); }

struct Unit { int pm, pn; };
struct Gemm { const bf16_t* A; const bf16_t* Bt; int M, N, K; };

struct StaticOrder {
    int nM, nN, nwg, G, c;
    __device__ void init(int M, int N, int G_, int c_) { nM = M / BM; nN = N / BM; nwg = nM * nN; G = G_; c = c_; }
    __device__ bool next(int i, Unit& u) const {
        const long L = (long)i * G + c; if (L >= nwg) return false;
        int wgid = (int)L; { const int q = nwg / NXCD, r = nwg % NXCD, xcd = wgid % NXCD, off = wgid / NXCD; wgid = (xcd < r ? xcd * (q + 1) : r * (q + 1) + (xcd - r) * q) + off; }
        const int nig = WGM * nN, gid = wgid / nig, fm = gid * WGM, gsz = (nM - fm) < WGM ? (nM - fm) : WGM;
        u.pm = fm + ((wgid % nig) % gsz); u.pn = (wgid % nig) / gsz; return true;
    }
};

template <class Epi, class Sched, bool ALIGN_EPI, int K>
__device__ __forceinline__ void gemm_phase(LAS unsigned char* lds, const Gemm g, const Sched& S, const Epi& E, const int tid) {
    const int wid = __builtin_amdgcn_readfirstlane(tid >> 6), lane = tid & 63, wr = wid >> 2, wc = wid & 3, fr = lane & 15, fq = lane >> 4;
    constexpr int nt = K / BK;
    unsigned voffA[2], voffB[2];
#pragma unroll
    for (int i = 0; i < 2; ++i) { int R, C; stage_rc(tid * 16 + i * 8192, R, C); const int Rb = Epi::PERM ? ((R & ~31) + perm32(R & 31)) : R;
        voffA[i] = (unsigned)(R * K + C) * 2u; voffB[i] = (unsigned)(Rb * K + C) * 2u; }
    const size_t kstep = (size_t)(BK * 2);
    const size_t hstep = (size_t)HALF * K * 2;
    const size_t tstep = 2 * hstep;
    const unsigned ldsw = (unsigned)wid * 1024u;
    const int aoff = lds_byte(wr * 64 + fr, fq * 8), boff = lds_byte(wc * 32 + fr, fq * 8);
#define PG8_SA(b, h) (((b) * 2 + (h)) * HTB)
#define PG8_SB(b, h) ((4 + (b) * 2 + (h)) * HTB)
#define PG8_STAGE(bufoff, gbase, voff) do { _Pragma("unroll") for (int _i = 0; _i < 2; ++_i) \
        __builtin_amdgcn_global_load_lds((const unsigned*)((const char*)(gbase) + (voff)[_i]), (LAS unsigned*)(lds + (bufoff) + ldsw + _i * 8192), 16, 0, 0); } while (0)
#define PG8_LDA(dst, b, h) do { _Pragma("unroll") for (int m = 0; m < 4; ++m) _Pragma("unroll") for (int k = 0; k < 2; ++k) dst[m][k] = *(const LAS bf16x8*)(lds + PG8_SA(b, h) + aoff + m * 2048 + k * 1024); } while (0)
#define PG8_LDB(dst, b, h) do { _Pragma("unroll") for (int n = 0; n < 2; ++n) _Pragma("unroll") for (int k = 0; k < 2; ++k) dst[n][k] = *(const LAS bf16x8*)(lds + PG8_SB(b, h) + boff + n * 2048 + k * 1024); } while (0)
#define PG8_MMA(ai, bj, At, Bt) do { __builtin_amdgcn_s_setprio(1); _Pragma("unroll") for (int m = 0; m < 4; ++m) _Pragma("unroll") for (int n = 0; n < 2; ++n) _Pragma("unroll") for (int k = 0; k < 2; ++k) \
        acc[ai][bj][m][n] = __builtin_amdgcn_mfma_f32_16x16x32_bf16(Bt[n][k], At[m][k], acc[ai][bj][m][n], 0, 0, 0); __builtin_amdgcn_s_setprio(0); } while (0)
#define PG8_WAIT_V(n) asm volatile("s_waitcnt vmcnt(" #n ")" ::: "memory")
#define PG8_WAIT_L(n) asm volatile("s_waitcnt lgkmcnt(" #n ")" ::: "memory")
#define PG8_BAR __builtin_amdgcn_s_barrier()
#define PG8_SCHED __builtin_amdgcn_sched_barrier(0)
    Unit cur, nxt; int ui = 0;
    if (!S.next(0, cur)) return;
    f32x4 acc[2][2][4][2];
#pragma unroll
    for (int a = 0; a < 2; ++a)
#pragma unroll
        for (int b = 0; b < 2; ++b)
#pragma unroll
            for (int m = 0; m < 4; ++m)
#pragma unroll
                for (int n = 0; n < 2; ++n) acc[a][b][m][n] = (f32x4){0.f, 0.f, 0.f, 0.f};
    bf16x8 At[4][2], B0[2][2], B1[2][2];
    const char* cA = (const char*)g.A + (size_t)cur.pm * tstep; const char* cB = (const char*)g.Bt + (size_t)cur.pn * tstep;
    PG8_STAGE(PG8_SB(0, 0), cB, voffB); PG8_STAGE(PG8_SB(0, 1), cB + hstep, voffB); PG8_STAGE(PG8_SA(0, 0), cA, voffA); PG8_STAGE(PG8_SA(0, 1), cA + hstep, voffA);
    if (wr == 1) PG8_BAR;
    PG8_WAIT_V(2); PG8_BAR;
    PG8_STAGE(PG8_SB(1, 0), cB + kstep, voffB); PG8_STAGE(PG8_SA(1, 0), cA + kstep, voffA); PG8_STAGE(PG8_SB(1, 1), cB + hstep + kstep, voffB);
    PG8_WAIT_V(6); PG8_BAR;
    for (;;) {
        const bool has_next = S.next(ui + 1, nxt);
        const char* nA = has_next ? (const char*)g.A + (size_t)nxt.pm * tstep : cA; const char* nB = has_next ? (const char*)g.Bt + (size_t)nxt.pn * tstep : cB;
        for (int t = 0; t < nt; t += 2) {
            const bool last = (t == nt - 2);
            const char* a1 = cA + (size_t)(t + 1) * kstep;
            const char* a2 = last ? nA : cA + (size_t)(t + 2) * kstep; const char* b2 = last ? nB : cB + (size_t)(t + 2) * kstep;
            const char* a3 = a2 + kstep; const char* b3 = b2 + kstep;
            PG8_LDB(B0, 0, 0); PG8_LDB(B1, 0, 1); PG8_SCHED; PG8_LDA(At, 0, 0); PG8_STAGE(PG8_SA(1, 1), a1 + hstep, voffA);
            PG8_WAIT_V(8); PG8_WAIT_L(0); PG8_BAR; PG8_MMA(0, 0, At, B0); PG8_MMA(0, 1, At, B1); PG8_BAR; PG8_SCHED;
            PG8_LDA(At, 0, 1); PG8_STAGE(PG8_SB(0, 0), b2, voffB); PG8_STAGE(PG8_SB(0, 1), b2 + hstep, voffB); PG8_STAGE(PG8_SA(0, 0), a2, voffA);
            PG8_WAIT_V(8); PG8_WAIT_L(0); PG8_BAR; PG8_MMA(1, 0, At, B0); PG8_MMA(1, 1, At, B1); PG8_BAR; PG8_SCHED;
            PG8_LDB(B0, 1, 0); PG8_LDB(B1, 1, 1); PG8_SCHED; PG8_LDA(At, 1, 0); PG8_STAGE(PG8_SA(0, 1), a2 + hstep, voffA);
            PG8_WAIT_V(8); PG8_WAIT_L(0); PG8_BAR; PG8_MMA(0, 0, At, B0); PG8_MMA(0, 1, At, B1); PG8_BAR; PG8_SCHED;
            PG8_LDA(At, 1, 1); PG8_STAGE(PG8_SB(1, 0), b3, voffB); PG8_STAGE(PG8_SB(1, 1), b3 + hstep, voffB); PG8_STAGE(PG8_SA(1, 0), a3, voffA);
            PG8_WAIT_V(8); PG8_WAIT_L(0); PG8_BAR; PG8_MMA(1, 0, At, B0); PG8_MMA(1, 1, At, B1); PG8_BAR; PG8_SCHED;
        }
        if constexpr (ALIGN_EPI) { if (wr == 0) PG8_BAR; }
        E(acc, cur, wr, wc, fr, fq);
        if (!has_next) break;
#pragma unroll
        for (int a = 0; a < 2; ++a)
#pragma unroll
            for (int b = 0; b < 2; ++b)
#pragma unroll
                for (int m = 0; m < 4; ++m)
#pragma unroll
                    for (int n = 0; n < 2; ++n) acc[a][b][m][n] = (f32x4){0.f, 0.f, 0.f, 0.f};
        cur = nxt; cA = nA; cB = nB; ++ui;
        if constexpr (ALIGN_EPI) { if (wr == 1) PG8_BAR; }
    }
    PG8_WAIT_V(0);
    if constexpr (!ALIGN_EPI) { if (wr == 0) PG8_BAR; }
    PG8_BAR;
#undef PG8_SA
#undef PG8_SB
#undef PG8_STAGE
#undef PG8_LDA
#undef PG8_LDB
#undef PG8_MMA
#undef PG8_WAIT_V
#undef PG8_WAIT_L
#undef PG8_BAR
#undef PG8_SCHED
}
}
using pg8::Unit;

struct EpiSwiGLU {
    static constexpr bool PERM = true;
    bf16_t* H;
    __device__ __forceinline__ void operator()(const f32x4 (&acc)[2][2][4][2], const Unit& u, int wr, int wc, int fr, int fq) const {
        const int row0 = u.pm * 256 + wr * 64 + fr, col0 = u.pn * 128 + wc * 32 + 8 * fq;
#pragma unroll
        for (int ai = 0; ai < 2; ++ai)
#pragma unroll
            for (int m = 0; m < 4; ++m) {
                bf16_t* rowp = H + (size_t)(row0 + ai * 128 + m * 16) * DFF + col0;
                float v[8];
#pragma unroll
                for (int n = 0; n < 2; ++n)
#pragma unroll
                    for (int i = 0; i < 4; ++i) { const float a = acc[ai][0][m][n][i], gg = acc[ai][1][m][n][i];
                        v[n * 4 + i] = a * gg * __builtin_amdgcn_rcpf(1.0f + __builtin_amdgcn_exp2f(-gg * LOG2E)); }
                u32x4 w; w.x = cvt_pk_bf16(v[0], v[1]); w.y = cvt_pk_bf16(v[2], v[3]); w.z = cvt_pk_bf16(v[4], v[5]); w.w = cvt_pk_bf16(v[6], v[7]);
                *(u32x4*)rowp = w;
            }
    }
};

template <bool HALFSTEP> struct EpiZ {
    static constexpr bool PERM = false;
    const float* res_lat; const float* res_ctx; float* X; const float* gate;
    __device__ __forceinline__ void operator()(const f32x4 (&acc)[2][2][4][2], const Unit& u, int wr, int wc, int fr, int fq) const {
        const int b = u.pm < 128 ? (u.pm >> 3) : 16;
        const int col0 = u.pn * 256 + wc * 32 + 4 * fq;
        const float s = HALFSTEP ? 0.5f : 1.0f;
        f32x2* stats = (f32x2*)((unsigned char*)X - WS_X + WS_STATS);
        f32x4 gv[2][2];
#pragma unroll
        for (int bj = 0; bj < 2; ++bj)
#pragma unroll
            for (int n = 0; n < 2; ++n) gv[bj][n] = *(const f32x4*)(gate + (size_t)b * (NMOD * DM) + col0 + bj * 128 + n * 16) * s;
#pragma unroll
        for (int ai = 0; ai < 2; ++ai)
#pragma unroll
            for (int m = 0; m < 4; ++m) {
                const int row = u.pm * 256 + ai * 128 + wr * 64 + m * 16 + fr;
                const float* rp = (row < MLAT ? res_lat + (size_t)row * DM : res_ctx + (size_t)(row - MLAT) * DM) + col0;
                float* xp = X + (size_t)row * DM + col0;
                f32x4 z[2][2]; float sum = 0.f;
#pragma unroll
                for (int bj = 0; bj < 2; ++bj)
#pragma unroll
                    for (int n = 0; n < 2; ++n) { const f32x4 r = *(const f32x4*)(rp + bj * 128 + n * 16);
                        z[bj][n] = r * ALPHA + gv[bj][n] * acc[ai][bj][m][n];
                        sum += (z[bj][n][0] + z[bj][n][1]) + (z[bj][n][2] + z[bj][n][3]); }
                sum += __shfl_xor(sum, 16); sum += __shfl_xor(sum, 32);
                const float mw = sum * (1.0f / 64.0f); float q = 0.f;
#pragma unroll
                for (int bj = 0; bj < 2; ++bj)
#pragma unroll
                    for (int n = 0; n < 2; ++n) { const f32x4 d = z[bj][n] - mw; q += (d[0] * d[0] + d[1] * d[1]) + (d[2] * d[2] + d[3] * d[3]);
                        *(f32x4*)(xp + bj * 128 + n * 16) = z[bj][n]; }
                q += __shfl_xor(q, 16); q += __shfl_xor(q, 32);
                if (fq == 0) stats[(size_t)row * 16 + u.pn * 4 + wc] = (f32x2){mw, q};
            }
    }
};

struct EpiQKV {
    static constexpr bool PERM = false;
    bf16_t* Q; bf16_t* Kb; bf16_t* Vtl; bf16_t* Vtc; const float* bias; const float* rope;
    __device__ __forceinline__ void operator()(const f32x4 (&acc)[2][2][4][2], const Unit& u, int wr, int wc, int fr, int fq) const {
        if (u.pn < 4 && u.pm >= 128) return;
        const int cb0 = u.pn * 256 + wc * 32 + 4 * fq;
        f32x4 bv[2][2];
#pragma unroll
        for (int bj = 0; bj < 2; ++bj)
#pragma unroll
            for (int n = 0; n < 2; ++n) bv[bj][n] = *(const f32x4*)(bias + cb0 + bj * 128 + n * 16);
#pragma unroll
        for (int ai = 0; ai < 2; ++ai)
#pragma unroll
            for (int m = 0; m < 4; ++m) {
                const int row = u.pm * 256 + ai * 128 + wr * 64 + m * 16 + fr;
                if (u.pn < 5) {
                    const int l = row & (SEQ - 1);
                    const int pos = (wc & 1) ? (l & 63) : (l >> 6);
                    f32x4 cs01 = *(const f32x4*)(rope + (pos * 16 + 4 * fq) * 2), cs23 = *(const f32x4*)(rope + (pos * 16 + 4 * fq) * 2 + 4);
                    if (row >= MLAT) { cs01 = (f32x4){1.f, 0.f, 1.f, 0.f}; cs23 = cs01; }
                    const float cc[4] = {cs01[0], cs01[2], cs23[0], cs23[2]}, ss[4] = {cs01[1], cs01[3], cs23[1], cs23[3]};
                    const float sc = (u.pn < 4) ? QSCALE : 1.0f;
#pragma unroll
                    for (int bj = 0; bj < 2; ++bj) {
                        const f32x4 x1 = acc[ai][bj][m][0] + bv[bj][0], x2 = acc[ai][bj][m][1] + bv[bj][1];
                        float o1[4], o2[4];
#pragma unroll
                        for (int i = 0; i < 4; ++i) { o1[i] = (x1[i] * cc[i] - x2[i] * ss[i]) * sc; o2[i] = (x1[i] * ss[i] + x2[i] * cc[i]) * sc; }
                        u32x2 w1, w2; w1.x = cvt_pk_bf16(o1[0], o1[1]); w1.y = cvt_pk_bf16(o1[2], o1[3]); w2.x = cvt_pk_bf16(o2[0], o2[1]); w2.y = cvt_pk_bf16(o2[2], o2[3]);
                        bf16_t* dst = (u.pn < 4) ? Q + (size_t)row * DM + cb0 + bj * 128 : Kb + (size_t)row * 256 + (cb0 - 1024) + bj * 128;
                        *(u32x2*)dst = w1; *(u32x2*)(dst + 16) = w2;
                    }
                } else {
#pragma unroll
                    for (int bj = 0; bj < 2; ++bj)
#pragma unroll
                        for (int n = 0; n < 2; ++n) {
                            const f32x4 v = acc[ai][bj][m][n] + bv[bj][n];
                            const int vcol = cb0 - 1280 + bj * 128 + n * 16, kvh = vcol >> 6, d = vcol & 63;
                            bf16_t* dst;
                            size_t pitch;
                            if (row < MLAT) { const int bb = row >> 11, l = row & (SEQ - 1); dst = Vtl + ((size_t)((bb * 4 + kvh) * 64 + d)) * SEQ + l; pitch = SEQ; }
                            else { const int r2 = row - MLAT, bb = r2 >> 8, l = r2 & 255; dst = Vtc + ((size_t)((bb * 4 + kvh) * 64 + d)) * CTXL + l; pitch = CTXL; }
#pragma unroll
                            for (int i = 0; i < 4; ++i) dst[(size_t)i * pitch] = (bf16_t)f2bf(v[i]);
                        }
                }
            }
    }
};

struct EpiDFT {
    static constexpr bool PERM = true;
    bf16_t* P;
    __device__ __forceinline__ void operator()(const f32x4 (&acc)[2][2][4][2], const Unit& u, int wr, int wc, int fr, int fq) const {
#pragma unroll
        for (int ai = 0; ai < 2; ++ai)
#pragma unroll
            for (int m = 0; m < 4; ++m) {
                const int row = u.pm * 256 + ai * 128 + wr * 64 + m * 16 + fr, cs = row >> 11, lp = row & (SEQ - 1);
#pragma unroll
                for (int bj = 0; bj < 2; ++bj) {
                    const int col = u.pn * 256 + bj * 128 + wc * 32 + 8 * fq, bb = col >> 10, j = col & 1023;
                    const f32x4 v0 = acc[ai][bj][m][0], v1 = acc[ai][bj][m][1];
                    u32x4 w; w.x = cvt_pk_bf16(v0[0], v0[1]); w.y = cvt_pk_bf16(v0[2], v0[3]); w.z = cvt_pk_bf16(v1[0], v1[1]); w.w = cvt_pk_bf16(v1[2], v1[3]);
                    *(u32x4*)(P + ((size_t)(bb * SEQ + lp)) * 2048 + cs * 1024 + j) = w;
                }
            }
    }
};

struct Params {
    const float *x, *c, *ctx, *c_ctx, *mod_w, *mod_b, *ln_g, *ln_b, *ffn_wi, *ffn_wo, *attn_wqkv, *attn_bqkv, *attn_wo, *attn_sink, *fourier_wo;
    float* out; unsigned char* ws;
};

__device__ __forceinline__ float wave_sum16(float v) {
#pragma unroll
    for (int o = 1; o < 16; o <<= 1) v += __shfl_xor(v, o);
    return v;
}

template <bool WIMAP>
__device__ __forceinline__ void transpose_item(const float* W, int K, int N, bf16_t* WT, LAS float* scr, int item, int lane) {
    const int nblk = N / 32, kb = item / nblk, nb = item % nblk, k0 = 64 * kb, n0 = 32 * nb;
    int d0 = n0;
    if (WIMAP) d0 = (n0 < DFF) ? ((n0 >> 7) * 256 + (n0 & 127)) : ((((n0 - DFF) >> 7) * 256) + 128 + ((n0 - DFF) & 127));
#pragma unroll 8
    for (int i = 0; i < 32; ++i) { const int kk = 2 * i + (lane >> 5); scr[kk * 33 + (lane & 31)] = W[(size_t)(k0 + kk) * N + n0 + (lane & 31)]; }
    asm volatile("s_waitcnt lgkmcnt(0)" ::: "memory");
    const int c = lane & 7;
#pragma unroll
    for (int j = 0; j < 4; ++j) { const int n = (lane >> 3) + 8 * j; const LAS float* s = scr + (8 * c) * 33 + n;
        u32x4 o; o.x = pk2(s[0 * 33], s[1 * 33]); o.y = pk2(s[2 * 33], s[3 * 33]); o.z = pk2(s[4 * 33], s[5 * 33]); o.w = pk2(s[6 * 33], s[7 * 33]);
        *(u32x4*)(WT + (size_t)(d0 + n) * K + k0 + 8 * c) = o; }
    asm volatile("s_waitcnt lgkmcnt(0)" ::: "memory");
}

__device__ __forceinline__ void prologue_a(const Params& p, LAS unsigned char* lds, int tid, int lane, int wid, int G) {
    unsigned char* ws = p.ws;
    float* mod = (float*)(ws + WS_MOD);
    LAS float* st = (LAS float*)lds;
    LAS float* red = (LAS float*)(lds + 81920);
    LAS f32x2* tab = (LAS f32x2*)(lds + 120832);
    for (int idx = tid; idx < 17 * 1024; idx += 512) { const int b = idx >> 10, k = idx & 1023; const float v = b < 16 ? p.c[b * 1024 + k] : p.c_ctx[k];
        st[k * 20 + b] = v / (1.0f + __expf(-v)); }
    if (tid < 256) tab[tid] = (f32x2){cospif((float)tid * (1.0f / 128.0f)), sinpif((float)tid * (1.0f / 128.0f))};
    __syncthreads();
    for (int item = blockIdx.x; item < 288; item += G) {
        const int layer = item / 144, n0 = (item % 144) * 64;
        const float* W = p.mod_w + (size_t)layer * DM * (NMOD * DM) + n0 + lane;
        float a[17];
#pragma unroll
        for (int b = 0; b < 17; ++b) a[b] = 0.f;
        const int kbeg = wid * 128;
#pragma unroll 4
        for (int k = kbeg; k < kbeg + 128; ++k) {
            const float w = W[(size_t)k * (NMOD * DM)];
            const LAS float* sp = st + k * 20;
            const f32x4 s0 = *(const LAS f32x4*)sp, s1 = *(const LAS f32x4*)(sp + 4), s2 = *(const LAS f32x4*)(sp + 8), s3 = *(const LAS f32x4*)(sp + 12); const float s4 = sp[16];
            a[0] += w * s0[0]; a[1] += w * s0[1]; a[2] += w * s0[2]; a[3] += w * s0[3];
            a[4] += w * s1[0]; a[5] += w * s1[1]; a[6] += w * s1[2]; a[7] += w * s1[3];
            a[8] += w * s2[0]; a[9] += w * s2[1]; a[10] += w * s2[2]; a[11] += w * s2[3];
            a[12] += w * s3[0]; a[13] += w * s3[1]; a[14] += w * s3[2]; a[15] += w * s3[3];
            a[16] += w * s4;
        }
#pragma unroll
        for (int b = 0; b < 17; ++b) red[(wid * 17 + b) * 64 + lane] = a[b];
        __syncthreads();
        for (int idx = tid; idx < 17 * 64; idx += 512) { const int b = idx >> 6, n = idx & 63; float s = 0.f;
#pragma unroll
            for (int w = 0; w < 8; ++w) s += red[(w * 17 + b) * 64 + n];
            mod[((size_t)layer * 17 + b) * (NMOD * DM) + n0 + n] = s + p.mod_b[layer * (NMOD * DM) + n0 + n]; }
        __syncthreads();
    }
    if (blockIdx.x == (unsigned)(G - 1)) {
        float* rope = (float*)(ws + WS_ROPE);
        for (int idx = tid; idx < 1024; idx += 512) { const int pos = idx >> 4, f = idx & 15;
            const float inv = powf(10000.0f, -(float)(2 * f) / 32.0f); const float ang = (float)pos * inv;
            rope[idx * 2] = cosf(ang); rope[idx * 2 + 1] = sinf(ang); }
    }
    {
        bf16_t* wcs = (bf16_t*)(ws + WS_WCS);
        const int gw = blockIdx.x * 8 + wid, NGW = G * 8;
        for (int item = gw; item < 8192; item += NGW) {
            const int k = item >> 2, nch = item & 3, cs = k >> 10, g = (k >> 8) & 3, c = k & 255;
            const float* wp = p.fourier_wo + (size_t)(g * 256) * DM + nch * 256 + 4 * lane;
            f32x4 a = (f32x4){0.f, 0.f, 0.f, 0.f};
#pragma unroll 4
            for (int cp = 0; cp < 256; ++cp) { const f32x2 t = tab[(c * cp) & 255]; const float tv = cs ? -t[1] : t[0];
                a += *(const f32x4*)(wp + (size_t)cp * DM) * tv; }
            a = a * 0.001381067932004975f;
            bf16_t* dst = wcs + (size_t)(nch * 256 + 4 * lane) * 2048 + k;
#pragma unroll
            for (int i = 0; i < 4; ++i) dst[(size_t)i * 2048] = (bf16_t)f2bf(a[i]);
        }
    }
    __syncthreads();
    {
        LAS float* scr = (LAS float*)(lds + wid * 16384);
        const int gw = blockIdx.x * 8 + wid, NGW = G * 8;
        constexpr int I_WI = (DM / 64) * (2 * DFF / 32), I_WO = (DFF / 64) * (DM / 32), I_QKV = (DM / 64) * (QKVW / 32), I_AWO = (DM / 64) * (DM / 32);
        constexpr int NITEMS = 4 * I_WI + 4 * I_WO + I_QKV + I_AWO;
        for (int it = gw; it < NITEMS; it += NGW) {
            int r = it;
            if (r < 4 * I_WI) { const int w = r / I_WI; transpose_item<true>(p.ffn_wi + (size_t)w * DM * 2 * DFF, DM, 2 * DFF, (bf16_t*)(ws + WS_WI + w * WI_BYTES), scr, r % I_WI, lane); continue; } r -= 4 * I_WI;
            if (r < 4 * I_WO) { const int w = r / I_WO; transpose_item<false>(p.ffn_wo + (size_t)w * DFF * DM, DFF, DM, (bf16_t*)(ws + WS_WO + w * WO_BYTES), scr, r % I_WO, lane); continue; } r -= 4 * I_WO;
            if (r < I_QKV) { transpose_item<false>(p.attn_wqkv, DM, QKVW, (bf16_t*)(ws + WS_WQKV), scr, r, lane); continue; } r -= I_QKV;
            transpose_item<false>(p.attn_wo, DM, DM, (bf16_t*)(ws + WS_AWO), scr, r, lane);
        }
    }
}

__device__ __forceinline__ void prologue_b(const Params& p, int lane, int gw, int NGW) {
    const float* mod = (const float*)(p.ws + WS_MOD);
    bf16_t* h = (bf16_t*)(p.ws + WS_H);
    for (int row = gw; row < MTOT; row += NGW) {
        const float* src = row < MLAT ? p.x + (size_t)row * DM : p.ctx + (size_t)(row - MLAT) * DM;
        const int b = row < MLAT ? (row >> 11) : 16;
        const float* sh = mod + (size_t)b * (NMOD * DM); const float* sc = sh + DM;
#pragma unroll
        for (int j = 0; j < 4; ++j) { const int col = 4 * lane + 256 * j;
            const f32x4 v = *(const f32x4*)(src + col), s1 = *(const f32x4*)(sc + col), s0 = *(const f32x4*)(sh + col);
            const f32x4 o = v * (s1 + 1.0f) + s0;
            u32x2 w; w.x = cvt_pk_bf16(o[0], o[1]); w.y = cvt_pk_bf16(o[2], o[3]);
            *(u32x2*)(h + (size_t)row * DM + col) = w; }
    }
}

__device__ __forceinline__ void ln_row_stats(const f32x2* stats, int row, int lane, float& mean, float& rstd) {
    const f32x2 st = stats[(size_t)row * 16 + (lane & 15)];
    mean = wave_sum16(st[0]) * (1.0f / 16.0f);
    const float dm = st[0] - mean;
    const float q = wave_sum16(st[1] + 64.0f * dm * dm);
    rstd = 1.0f / sqrtf(q * (1.0f / 1024.0f) + LN_EPS);
}
template <int MODE>
__device__ __forceinline__ void ln_apply(const Params& p, LAS unsigned char* lds, int M, const float* g, const float* bt, const float* modn, int nj, int tid, int lane, int wid, int G) {
    float* X = (float*)(p.ws + WS_X);
    bf16_t* h = (bf16_t*)(p.ws + WS_H);
    const f32x2* stats = (const f32x2*)(p.ws + WS_STATS);
    if (MODE != 2) {
        const int gw = blockIdx.x * 8 + wid, NGW = G * 8;
        for (int row = gw; row < M; row += NGW) {
            float mean, rstd; ln_row_stats(stats, row, lane, mean, rstd);
            const int b = row < MLAT ? (row >> 11) : 16;
            const float* sh = modn + ((size_t)b * NMOD + 3 * nj) * DM; const float* sc = sh + DM;
#pragma unroll
            for (int j = 0; j < 4; ++j) { const int col = 4 * lane + 256 * j;
                const f32x4 z = *(const f32x4*)(X + (size_t)row * DM + col), gg = *(const f32x4*)(g + col), bb = *(const f32x4*)(bt + col);
                const f32x4 xv = (z - mean) * rstd * gg + bb;
                if (MODE == 1) { *(f32x4*)(p.out + (size_t)row * DM + col) = xv; }
                else { *(f32x4*)(X + (size_t)row * DM + col) = xv;
                    const f32x4 o = xv * (*(const f32x4*)(sc + col) + 1.0f) + *(const f32x4*)(sh + col);
                    u32x2 w; w.x = cvt_pk_bf16(o[0], o[1]); w.y = cvt_pk_bf16(o[2], o[3]);
                    *(u32x2*)(h + (size_t)row * DM + col) = w; } }
        }
    } else {
        constexpr int PITCH = 2064;
        for (int chunk = blockIdx.x; chunk < MLAT / 32; chunk += G) {
            const int row0 = chunk * 32, b = row0 >> 11, l0 = row0 & (SEQ - 1);
            const float* sh = modn + ((size_t)b * NMOD + 3 * nj) * DM; const float* sc = sh + DM;
#pragma unroll 1
            for (int rr = 0; rr < 4; ++rr) {
                const int lr = wid * 4 + rr, row = row0 + lr;
                float mean, rstd; ln_row_stats(stats, row, lane, mean, rstd);
#pragma unroll
                for (int j = 0; j < 4; ++j) { const int col = 4 * lane + 256 * j;
                    const f32x4 z = *(const f32x4*)(X + (size_t)row * DM + col), gg = *(const f32x4*)(g + col), bb = *(const f32x4*)(bt + col);
                    const f32x4 xv = (z - mean) * rstd * gg + bb;
                    *(f32x4*)(X + (size_t)row * DM + col) = xv;
                    const f32x4 o = xv * (*(const f32x4*)(sc + col) + 1.0f) + *(const f32x4*)(sh + col);
                    u32x2 w; w.x = cvt_pk_bf16(o[0], o[1]); w.y = cvt_pk_bf16(o[2], o[3]);
                    *(LAS u32x2*)(lds + lr * PITCH + col * 2) = w; }
            }
            __syncthreads();
#pragma unroll 1
            for (int jj = 0; jj < 2; ++jj) {
                const int j = tid + 512 * jj;
                unsigned wv[16];
#pragma unroll
                for (int q = 0; q < 16; ++q) { const unsigned lo = *(const LAS bf16_t*)(lds + (2 * q) * PITCH + j * 2), hi = *(const LAS bf16_t*)(lds + (2 * q + 1) * PITCH + j * 2); wv[q] = lo | (hi << 16); }
                bf16_t* dst = h + ((size_t)(b * DM + j)) * SEQ + l0;
#pragma unroll
                for (int q = 0; q < 4; ++q) *(u32x4*)(dst + 8 * q) = (u32x4){wv[4 * q], wv[4 * q + 1], wv[4 * q + 2], wv[4 * q + 3]};
            }
            __syncthreads();
        }
    }
}

__device__ __forceinline__ void gen_T(const Params& p, int lane, int gw, int NGW) {
    bf16_t* T = (bf16_t*)(p.ws + WS_T);
    for (int r = gw; r < 4096; r += NGW) {
        const int cs = r >> 11, lp = r & (SEQ - 1);
#pragma unroll 1
        for (int jj = 0; jj < 4; ++jj) {
            const int l0 = 8 * lane + 512 * jj; float v[8];
#pragma unroll
            for (int i = 0; i < 8; ++i) { const int idx = ((l0 + i) * lp) & (SEQ - 1); const float a = (float)idx * (1.0f / 1024.0f); v[i] = cs ? sinpif(a) : cospif(a); }
            u32x4 w; w.x = pk2(v[0], v[1]); w.y = pk2(v[2], v[3]); w.z = pk2(v[4], v[5]); w.w = pk2(v[6], v[7]);
            *(u32x4*)(T + (size_t)r * SEQ + l0) = w;
        }
    }
}

__device__ __forceinline__ void attn_phase(const Params& p, LAS unsigned char* lds, int tid, int lane, int wid, int G) {
    const bf16_t* Q = (const bf16_t*)(p.ws + WS_Q); const bf16_t* Kb = (const bf16_t*)(p.ws + WS_K);
    const bf16_t* Vtl = (const bf16_t*)(p.ws + WS_VTL); const bf16_t* Vtc = (const bf16_t*)(p.ws + WS_VTC);
    bf16_t* O = (bf16_t*)(p.ws + WS_O);
    constexpr int RP = 144;
    constexpr int TB = 64 * RP;
    const int r32 = lane & 31, hi = lane >> 5;
    const int lrow = tid >> 3, lch = tid & 7;
    for (int unit = blockIdx.x; unit < 2048; unit += G) {
        const int qb = unit & 31, kvh = (unit >> 5) & 3, b = unit >> 7;
        const int q0 = qb * 64, head = kvh * 4 + (wid & 3), qrow = q0 + 32 * (wid >> 2) + r32;
        const bf16_t* Qp = Q + ((size_t)(b * SEQ + qrow)) * DM + head * 64 + 8 * hi;
        bf16x8 qr[4];
#pragma unroll
        for (int d0 = 0; d0 < 4; ++d0) qr[d0] = *(const bf16x8*)(Qp + 16 * d0);
        const int t0 = q0 >= 128 ? 0 : (128 - q0) / 64;
        const int tl = (2112 - q0) / 64 < 4 ? (2112 - q0) / 64 : 4;
        const bf16_t* kwin = Kb + ((size_t)(b * SEQ + q0 - 128 + lrow)) * 256 + kvh * 64 + lch * 8;
        const bf16_t* kctx = Kb + ((size_t)(MLAT + b * CTXL + lrow)) * 256 + kvh * 64 + lch * 8;
        const bf16_t* vwin = Vtl + ((size_t)((b * 4 + kvh) * 64 + lrow)) * SEQ + (q0 - 128) + lch * 8;
        const bf16_t* vctx = Vtc + ((size_t)((b * 4 + kvh) * 64 + lrow)) * CTXL + lch * 8;
        float mrun = -1e30f, lsum = 0.f;
        f32x16 o0, o1;
#pragma unroll
        for (int r = 0; r < 16; ++r) { o0[r] = 0.f; o1[r] = 0.f; }
        int t = t0, buf = 0;
        u32x4 kreg, vreg;
        kreg = *(const u32x4*)(t < 5 ? kwin + (size_t)t * 64 * 256 : kctx + (size_t)(t - 5) * 64 * 256);
        vreg = *(const u32x4*)(t < 5 ? vwin + t * 64 : vctx + (t - 5) * 64);
        *(LAS u32x4*)(lds + lrow * RP + lch * 16) = kreg;
        *(LAS u32x4*)(lds + 2 * TB + lrow * RP + lch * 16) = vreg;
        __syncthreads();
        for (;;) {
            const bool has_next = (t != 8);
            const int tn = (t == tl) ? 5 : t + 1;
            if (has_next) {
                kreg = *(const u32x4*)(tn < 5 ? kwin + (size_t)tn * 64 * 256 : kctx + (size_t)(tn - 5) * 64 * 256);
                vreg = *(const u32x4*)(tn < 5 ? vwin + tn * 64 : vctx + (tn - 5) * 64);
            }
            const LAS unsigned char* Kt = lds + buf * TB;
            const LAS unsigned char* Vt = lds + 2 * TB + buf * TB;
            f32x16 p0, p1;
#pragma unroll
            for (int r = 0; r < 16; ++r) { p0[r] = 0.f; p1[r] = 0.f; }
#pragma unroll
            for (int d0 = 0; d0 < 4; ++d0) {
                const bf16x8 a0 = *(const LAS bf16x8*)(Kt + r32 * RP + (16 * d0 + 8 * hi) * 2);
                const bf16x8 a1 = *(const LAS bf16x8*)(Kt + (r32 + 32) * RP + (16 * d0 + 8 * hi) * 2);
                p0 = __builtin_amdgcn_mfma_f32_32x32x16_bf16(a0, qr[d0], p0, 0, 0, 0);
                p1 = __builtin_amdgcn_mfma_f32_32x32x16_bf16(a1, qr[d0], p1, 0, 0, 0);
            }
            if (t < 5) {
                const int kb = q0 - 128 + 64 * t + 4 * hi - qrow;
#pragma unroll
                for (int r = 0; r < 16; ++r) { const int dd = kb + (r & 3) + 8 * (r >> 2);
                    if (dd > 128 || dd < -128) p0[r] = -1e30f;
                    if (dd + 32 > 128 || dd + 32 < -128) p1[r] = -1e30f; }
            }
            float tm = fmaxf(p0[0], p1[0]);
#pragma unroll
            for (int r = 1; r < 16; ++r) tm = fmaxf(tm, fmaxf(p0[r], p1[r]));
            tm = fmaxf(tm, __shfl_xor(tm, 32));
            const float mnew = fmaxf(mrun, tm);
            const float alpha = __builtin_amdgcn_exp2f(mrun - mnew);
            mrun = mnew;
            float ps = 0.f;
#pragma unroll
            for (int r = 0; r < 16; ++r) { p0[r] = __builtin_amdgcn_exp2f(p0[r] - mnew); p1[r] = __builtin_amdgcn_exp2f(p1[r] - mnew); ps += p0[r] + p1[r]; }
            lsum = lsum * alpha + ps;
#pragma unroll
            for (int r = 0; r < 16; ++r) { o0[r] *= alpha; o1[r] *= alpha; }
#pragma unroll
            for (int kk = 0; kk < 4; ++kk) {
                const int half = kk >> 1, s = kk & 1, kvb = 32 * half + 16 * s;
                u32x4 pw;
                if (half == 0) { pw.x = cvt_pk_bf16(p0[8 * s + 0], p0[8 * s + 1]); pw.y = cvt_pk_bf16(p0[8 * s + 2], p0[8 * s + 3]); pw.z = cvt_pk_bf16(p0[8 * s + 4], p0[8 * s + 5]); pw.w = cvt_pk_bf16(p0[8 * s + 6], p0[8 * s + 7]); }
                else           { pw.x = cvt_pk_bf16(p1[8 * s + 0], p1[8 * s + 1]); pw.y = cvt_pk_bf16(p1[8 * s + 2], p1[8 * s + 3]); pw.z = cvt_pk_bf16(p1[8 * s + 4], p1[8 * s + 5]); pw.w = cvt_pk_bf16(p1[8 * s + 6], p1[8 * s + 7]); }
                const bf16x8 pf = __builtin_bit_cast(bf16x8, pw);
                const u32x2 va0 = *(const LAS u32x2*)(Vt + r32 * RP + (kvb + 4 * hi) * 2), va1 = *(const LAS u32x2*)(Vt + r32 * RP + (kvb + 8 + 4 * hi) * 2);
                const u32x2 vb0 = *(const LAS u32x2*)(Vt + (r32 + 32) * RP + (kvb + 4 * hi) * 2), vb1 = *(const LAS u32x2*)(Vt + (r32 + 32) * RP + (kvb + 8 + 4 * hi) * 2);
                const bf16x8 vfa = __builtin_bit_cast(bf16x8, ((u32x4){va0.x, va0.y, va1.x, va1.y}));
                const bf16x8 vfb = __builtin_bit_cast(bf16x8, ((u32x4){vb0.x, vb0.y, vb1.x, vb1.y}));
                o0 = __builtin_amdgcn_mfma_f32_32x32x16_bf16(vfa, pf, o0, 0, 0, 0);
                o1 = __builtin_amdgcn_mfma_f32_32x32x16_bf16(vfb, pf, o1, 0, 0, 0);
            }
            if (has_next) {
                *(LAS u32x4*)(lds + (buf ^ 1) * TB + lrow * RP + lch * 16) = kreg;
                *(LAS u32x4*)(lds + 2 * TB + (buf ^ 1) * TB + lrow * RP + lch * 16) = vreg;
            }
            __syncthreads();
            if (!has_next) break;
            t = tn; buf ^= 1;
        }
        lsum += __shfl_xor(lsum, 32);
        lsum += __builtin_amdgcn_exp2f(p.attn_sink[head] * LOG2E - mrun);
        const float inv = 1.0f / lsum;
        bf16_t* Op = O + ((size_t)(b * SEQ + qrow)) * DM + head * 64 + 4 * hi;
#pragma unroll
        for (int gq = 0; gq < 4; ++gq) {
            u32x2 w0, w1;
            w0.x = cvt_pk_bf16(o0[4 * gq] * inv, o0[4 * gq + 1] * inv); w0.y = cvt_pk_bf16(o0[4 * gq + 2] * inv, o0[4 * gq + 3] * inv);
            w1.x = cvt_pk_bf16(o1[4 * gq] * inv, o1[4 * gq + 1] * inv); w1.y = cvt_pk_bf16(o1[4 * gq + 2] * inv, o1[4 * gq + 3] * inv);
            *(u32x2*)(Op + 8 * gq) = w0; *(u32x2*)(Op + 32 + 8 * gq) = w1;
        }
    }
}

enum { K_PROA = 0, K_PROB, K_WI, K_Z, K_LN, K_LNT, K_LNF, K_QKV, K_ATTN, K_DFT };
constexpr int NSTEPS = 21;

__global__ void __launch_bounds__(512, 2) fwd_megakernel(Params p_unused) {
    extern __shared__ __attribute__((aligned(16))) unsigned char lds_raw[];
    LAS unsigned char* lds = (LAS unsigned char*)lds_raw;
    cg::grid_group grid = cg::this_grid();
    const int G = gridDim.x, NGW = G * 8;
    typedef const __attribute__((address_space(4))) Params* kparams_t;

#pragma unroll 1
    for (int step = 0; step < NSTEPS; ++step) {
        int tid = threadIdx.x; asm volatile("" : "+v"(tid));
        const int lane = tid & 63, wid = __builtin_amdgcn_readfirstlane(tid >> 6), gw = blockIdx.x * 8 + wid;
        kparams_t kp = (kparams_t)__builtin_amdgcn_kernarg_segment_ptr(); asm volatile("" : "+s"(kp));
        const Params p = *(const Params*)kp;
        unsigned char* ws = p.ws;
        const float* mod = (const float*)(ws + WS_MOD);
        float* X = (float*)(ws + WS_X);
        bf16_t* hbuf = (bf16_t*)(ws + WS_H);
        bf16_t* hid = (bf16_t*)(ws + WS_HID);
        int kind, M = MLAT, widx = 0, zl = 0, zj = 0, lnl = 0, lnj = 0, nl = 0, nj = 0, zsrc = 0;
        switch (step) {
            case 0: kind = K_PROA; break;
            case 1: kind = K_PROB; break;
            case 2: kind = K_WI; M = MTOT; widx = 0; break;
            case 3: kind = K_Z; M = MTOT; widx = 0; zsrc = 0; zl = 0; zj = 0; break;
            case 4: kind = K_LN; M = MTOT; lnl = 0; lnj = 0; nl = 0; nj = 1; break;
            case 5: kind = K_QKV; break;
            case 6: kind = K_ATTN; break;
            case 7: kind = K_Z; zsrc = 1; zl = 0; zj = 1; break;
            case 8: kind = K_LN; lnl = 0; lnj = 1; nl = 0; nj = 2; break;
            case 9: kind = K_WI; widx = 1; break;
            case 10: kind = K_Z; widx = 1; zsrc = 0; zl = 0; zj = 2; break;
            case 11: kind = K_LN; lnl = 0; lnj = 2; nl = 1; nj = 0; break;
            case 12: kind = K_WI; widx = 2; break;
            case 13: kind = K_Z; widx = 2; zsrc = 0; zl = 1; zj = 0; break;
            case 14: kind = K_LNT; lnl = 1; lnj = 0; nl = 1; nj = 1; break;
            case 15: kind = K_DFT; break;
            case 16: kind = K_Z; zsrc = 2; zl = 1; zj = 1; break;
            case 17: kind = K_LN; lnl = 1; lnj = 1; nl = 1; nj = 2; break;
            case 18: kind = K_WI; widx = 3; break;
            case 19: kind = K_Z; widx = 3; zsrc = 0; zl = 1; zj = 2; break;
            default: kind = K_LNF; lnl = 1; lnj = 2; break;
        }
        const float* lg = p.ln_g + (lnl * 3 + lnj) * DM; const float* lb = p.ln_b + (lnl * 3 + lnj) * DM;
        const float* modn = mod + (size_t)nl * 17 * (NMOD * DM);
        if (kind == K_PROA) {
#ifndef DIS_PROA
            prologue_a(p, lds, tid, lane, wid, G);
#endif
        } else if (kind == K_PROB) {
            prologue_b(p, lane, gw, NGW);
        } else if (kind == K_WI) {
            pg8::Gemm g{hbuf, (const bf16_t*)(ws + WS_WI + (size_t)widx * WI_BYTES), M, 2 * DFF, DM};
            pg8::StaticOrder S; S.init(M, 2 * DFF, G, (int)blockIdx.x);
            EpiSwiGLU E{hid};
#ifndef DIS_WI
            pg8::gemm_phase<EpiSwiGLU, pg8::StaticOrder, true, DM>(lds, g, S, E, tid);
#endif
        } else if (kind == K_Z) {
            pg8::StaticOrder S; S.init(M, DM, G, (int)blockIdx.x);
            const bool first = (step == 3);
            const float* rl = first ? p.x : X; const float* rc = first ? p.ctx : X + (size_t)MLAT * DM;
            const float* gate = mod + ((size_t)zl * 17 * NMOD + 3 * zj + 2) * DM;
#ifndef DIS_Z
            if (zsrc == 0) { const pg8::Gemm g{hid, (const bf16_t*)(ws + WS_WO + (size_t)widx * WO_BYTES), M, DM, DFF}; const EpiZ<true> E{rl, rc, X, gate}; pg8::gemm_phase<EpiZ<true>, pg8::StaticOrder, true, DFF>(lds, g, S, E, tid); }
            else if (zsrc == 1) { const pg8::Gemm g{(const bf16_t*)(ws + WS_O), (const bf16_t*)(ws + WS_AWO), M, DM, DM}; const EpiZ<false> E{rl, rc, X, gate}; pg8::gemm_phase<EpiZ<false>, pg8::StaticOrder, true, DM>(lds, g, S, E, tid); }
            else { const pg8::Gemm g{(const bf16_t*)(ws + WS_P), (const bf16_t*)(ws + WS_WCS), M, DM, 2048}; const EpiZ<false> E{rl, rc, X, gate}; pg8::gemm_phase<EpiZ<false>, pg8::StaticOrder, true, 2048>(lds, g, S, E, tid); }
#endif
        } else if (kind == K_LN) {
            ln_apply<0>(p, lds, M, lg, lb, modn, nj, tid, lane, wid, G);
            if (step == 11) gen_T(p, lane, gw, NGW);
        } else if (kind == K_LNT) {
#ifndef DIS_LNT
            ln_apply<2>(p, lds, M, lg, lb, modn, nj, tid, lane, wid, G);
#endif
        } else if (kind == K_LNF) {
            ln_apply<1>(p, lds, M, lg, lb, modn, nj, tid, lane, wid, G);
        } else if (kind == K_QKV) {
            pg8::Gemm g{hbuf, (const bf16_t*)(ws + WS_WQKV), MTOT, QKVW, DM};
            pg8::StaticOrder S; S.init(MTOT, QKVW, G, (int)blockIdx.x);
            EpiQKV E{(bf16_t*)(ws + WS_Q), (bf16_t*)(ws + WS_K), (bf16_t*)(ws + WS_VTL), (bf16_t*)(ws + WS_VTC), p.attn_bqkv, (const float*)(ws + WS_ROPE)};
#ifndef DIS_QKV
            pg8::gemm_phase<EpiQKV, pg8::StaticOrder, true, DM>(lds, g, S, E, tid);
#endif
        } else if (kind == K_ATTN) {
#ifndef DIS_ATTN
            attn_phase(p, lds, tid, lane, wid, G);
#endif
        } else {
            pg8::Gemm g{(const bf16_t*)(ws + WS_T), hbuf, 4096, NB * DM, SEQ};
            pg8::StaticOrder S; S.init(4096, NB * DM, G, (int)blockIdx.x);
            EpiDFT E{(bf16_t*)(ws + WS_P)};
#ifndef DIS_DFT
            pg8::gemm_phase<EpiDFT, pg8::StaticOrder, true, SEQ>(lds, g, S, E, tid);
#endif
        }
        if (step + 1 < NSTEPS) grid.sync();
    }
}

extern "C" void kernel_launch(void* const* d_in, const int* in_sizes, int n_in, void* d_out, int out_size, void* d_ws, size_t ws_size, hipStream_t stream) {
    static int grid = 0;
    if (grid == 0) {
        if (n_in != 15 || ws_size < WS_END) { fprintf(stderr, "kernel_launch: unexpected n_in %d or ws_size %zu (< %zu)\n", n_in, ws_size, (size_t)WS_END); grid = -1; return; }
        int dev = 0, cus = 0, per_cu = 0;
        hipGetDevice(&dev);
        hipDeviceGetAttribute(&cus, hipDeviceAttributeMultiprocessorCount, dev);
        if (hipFuncSetAttribute((const void*)fwd_megakernel, hipFuncAttributeMaxDynamicSharedMemorySize, LDS_BYTES) != hipSuccess) fprintf(stderr, "kernel_launch: hipFuncSetAttribute failed\n");
        if (hipOccupancyMaxActiveBlocksPerMultiprocessor(&per_cu, (const void*)fwd_megakernel, 512, LDS_BYTES) != hipSuccess || per_cu < 1) { fprintf(stderr, "kernel_launch: occupancy query gave %d\n", per_cu); per_cu = 1; }
        (void)hipGetLastError();
        grid = cus * per_cu;
    }
    if (grid < 0) return;
    Params p{};
    p.x = (const float*)d_in[0]; p.c = (const float*)d_in[1]; p.ctx = (const float*)d_in[2]; p.c_ctx = (const float*)d_in[3];
    p.mod_w = (const float*)d_in[4]; p.mod_b = (const float*)d_in[5]; p.ln_g = (const float*)d_in[6]; p.ln_b = (const float*)d_in[7];
    p.ffn_wi = (const float*)d_in[8]; p.ffn_wo = (const float*)d_in[9]; p.attn_wqkv = (const float*)d_in[10]; p.attn_bqkv = (const float*)d_in[11];
    p.attn_wo = (const float*)d_in[12]; p.attn_sink = (const float*)d_in[13]; p.fourier_wo = (const float*)d_in[14];
    p.out = (float*)d_out; p.ws = (unsigned char*)d_ws;
    void* args[] = {&p};
    hipError_t e = hipLaunchCooperativeKernel((const void*)fwd_megakernel, dim3(grid), dim3(512), args, LDS_BYTES, stream);
    if (e != hipSuccess) fprintf(stderr, "cooperative launch failed: %s (grid %d)\n", hipGetErrorString(e), grid);
}
```
